# Optimizing an MI355X kernel written in HIP

```python
import math
import jax, jax.numpy as jnp
from jax import lax
import numpy as np

D_MODEL = 1024
BATCH = 4
SEQ = 8192
DEPTH = 1

D_MIX = D_MODEL
HEAD_DIM = 64
N_Q_HEADS = 8
N_KV_HEADS = 2
Q_PER_KV = N_Q_HEADS // N_KV_HEADS
D_ATTN = N_Q_HEADS * HEAD_DIM
D_CONV = D_MIX - D_ATTN
CONV_WIDTH = 31
WINDOW = 128
BLOCK = 128
N_BUCKETS = 32
MAX_EXACT = N_BUCKETS // 2
MAX_DISTANCE = 128
D_FF = int(math.ceil(8 * D_MODEL / 3 / 256) * 256)
EPS = 1e-6
D_Q = N_Q_HEADS * HEAD_DIM
D_KV = N_KV_HEADS * HEAD_DIM
D_IN = D_Q + 2 * D_KV + 2 * D_CONV

kernel_name = "hymba_conformer_swa_sink_hybrid"


def rms_norm(x, g):
    xf = x.astype(jnp.float32)
    y = xf * lax.rsqrt(jnp.mean(xf * xf, axis=-1, keepdims=True) + EPS)
    return (y * g.astype(jnp.float32)).astype(x.dtype)


def layer_norm(x, g, b):
    xf = x.astype(jnp.float32)
    mu = jnp.mean(xf, axis=-1, keepdims=True)
    var = jnp.mean(jnp.square(xf - mu), axis=-1, keepdims=True)
    y = (xf - mu) * lax.rsqrt(var + EPS)
    return (y * g.astype(jnp.float32) + b.astype(jnp.float32)).astype(x.dtype)


def t5_causal_bucket(dist):
    is_small = dist < MAX_EXACT
    d = jnp.maximum(dist, 1).astype(jnp.float32)
    large = MAX_EXACT + (jnp.log(d / MAX_EXACT) / math.log(MAX_DISTANCE / MAX_EXACT)
                         * (N_BUCKETS - MAX_EXACT)).astype(jnp.int32)
    large = jnp.minimum(large, N_BUCKETS - 1)
    return jnp.where(is_small, dist, large)


def conformer_conv(u, conv_dw, conv_dw_b, conv_ln_g, conv_ln_b, w_conv_pw):
    a, gate = jnp.split(u, 2, axis=-1)
    h = a * jax.nn.sigmoid(gate)
    h = lax.conv_general_dilated(
        h, conv_dw[:, None, :].astype(h.dtype), window_strides=(1,),
        padding=[(CONV_WIDTH - 1, 0)],
        dimension_numbers=("NWC", "WIO", "NWC"),
        feature_group_count=D_CONV) + conv_dw_b
    h = jax.nn.silu(layer_norm(h, conv_ln_g, conv_ln_b))
    return h @ w_conv_pw


def sliding_window_attention(q, k, v, attn_sinks, rel_bias):
    B, S = q.shape[0], q.shape[1]
    nb = S // BLOCK
    qb = q.reshape(B, nb, BLOCK, N_KV_HEADS, Q_PER_KV, HEAD_DIM)
    pad = ((0, 0), (BLOCK, 0), (0, 0), (0, 0))
    kp, vp = jnp.pad(k, pad), jnp.pad(v, pad)

    def band(t):
        prev = t[:, :S].reshape(B, nb, BLOCK, N_KV_HEADS, HEAD_DIM)
        cur = t[:, BLOCK:].reshape(B, nb, BLOCK, N_KV_HEADS, HEAD_DIM)
        return jnp.concatenate([prev, cur], axis=2)

    kb, vb = band(kp), band(vp)
    scale = 1.0 / math.sqrt(HEAD_DIM)
    s = jnp.einsum("bnqhgd,bnkhd->bnhgqk", qb, kb).astype(jnp.float32) * scale

    qi = jnp.arange(BLOCK)[:, None]
    kj = jnp.arange(2 * BLOCK)[None, :]
    dist = qi + BLOCK - kj
    in_band = (dist >= 0) & (dist < WINDOW)
    bucket = t5_causal_bucket(jnp.maximum(dist, 0))
    bias = rel_bias.astype(jnp.float32)[bucket]
    bias = jnp.transpose(bias, (2, 0, 1)).reshape(N_KV_HEADS, Q_PER_KV, BLOCK, 2 * BLOCK)
    blk = jnp.arange(nb)[:, None, None]
    valid = in_band[None] & ((blk > 0) | (kj[None] >= BLOCK))
    s = jnp.where(valid[None, :, None, None], s + bias, -jnp.inf)

    sink = attn_sinks.astype(jnp.float32).reshape(N_KV_HEADS, Q_PER_KV, 1, 1)
    m = jnp.maximum(jnp.max(s, axis=-1, keepdims=True), sink)
    p = jnp.exp(s - m)
    denom = jnp.sum(p, axis=-1, keepdims=True) + jnp.exp(sink - m)
    p = (p / denom).astype(v.dtype)
    o = jnp.einsum("bnhgqk,bnkhd->bnqhgd", p, vb)
    return o.reshape(B, S, N_Q_HEADS * HEAD_DIM)


def setup_inputs(seed: int = 0) -> dict:
    key = jax.random.key(seed)
    ks = jax.random.split(key, 20)
    f = jnp.float32
    nrm = lambda k, shp, sc: jax.random.normal(k, shp, f) * sc
    gain = lambda k, n: 1.0 + 0.05 * jax.random.normal(k, (n,), f)
    return {
        "x": jax.random.normal(ks[0], (BATCH, SEQ, D_MODEL), f),
        "mix_pre_g": gain(ks[1], D_MODEL),
        "mix_post_g": gain(ks[2], D_MODEL),
        "ffn_pre_g": gain(ks[3], D_MODEL),
        "ffn_post_g": gain(ks[4], D_MODEL),
        "w_in": nrm(ks[5], (D_MODEL, D_IN), D_MODEL ** -0.5),
        "conv_dw": nrm(ks[6], (CONV_WIDTH, D_CONV), CONV_WIDTH ** -0.5),
        "conv_dw_b": nrm(ks[7], (D_CONV,), 0.02),
        "conv_ln_g": gain(ks[8], D_CONV),
        "conv_ln_b": nrm(ks[9], (D_CONV,), 0.02),
        "w_conv_pw": nrm(ks[10], (D_CONV, D_CONV), D_CONV ** -0.5),
        "attn_sinks": nrm(ks[11], (N_Q_HEADS,), 0.5),
        "rel_bias": nrm(ks[12], (N_BUCKETS, N_Q_HEADS), 0.5),
        "w_out": nrm(ks[13], (D_MIX, D_MODEL), D_MIX ** -0.5),
        "w_gate": nrm(ks[14], (D_MODEL, D_FF), D_MODEL ** -0.5),
        "w_up": nrm(ks[15], (D_MODEL, D_FF), D_MODEL ** -0.5),
        "w_down": nrm(ks[16], (D_FF, D_MODEL), D_FF ** -0.5),
    }


def reference(x, mix_pre_g, mix_post_g, ffn_pre_g, ffn_post_g, w_in, conv_dw, conv_dw_b,
              conv_ln_g, conv_ln_b, w_conv_pw, attn_sinks, rel_bias, w_out,
              w_gate, w_up, w_down):
    B, S, _ = x.shape
    h = x
    for _layer in range(DEPTH):
        hn = rms_norm(h, mix_pre_g)
        proj = hn @ w_in
        q = proj[..., :D_Q].reshape(B, S, N_Q_HEADS, HEAD_DIM)
        k = proj[..., D_Q:D_Q + D_KV].reshape(B, S, N_KV_HEADS, HEAD_DIM)
        v = proj[..., D_Q + D_KV:D_Q + 2 * D_KV].reshape(B, S, N_KV_HEADS, HEAD_DIM)
        u = proj[..., D_Q + 2 * D_KV:]
        attn_out = sliding_window_attention(q, k, v, attn_sinks, rel_bias)
        conv_out = conformer_conv(u, conv_dw, conv_dw_b, conv_ln_g, conv_ln_b, w_conv_pw)
        mixed = jnp.concatenate([attn_out, conv_out], axis=-1) @ w_out
        h = h + rms_norm(mixed, mix_post_g)
        hn = rms_norm(h, ffn_pre_g)
        ff = (jax.nn.silu(hn @ w_gate) * (hn @ w_up)) @ w_down
        h = h + rms_norm(ff, ffn_post_g)
    return h
```

```cpp
#include <hip/hip_runtime.h>
#include <cstdio>
#include <cstdint>

constexpr int BATCH = 4, SEQ = 8192, DM = 1024, M = BATCH * SEQ;
constexpr int NH = 8, HD = 64, DQ = 512, DKV = 128, DCONV = 512, CWID = 31, DFF = 2816, DIN = 1792;
constexpr int QKVW = DQ + 2 * DKV;
constexpr float EPS = 1e-6f;

typedef unsigned short bf16;
typedef float f32x4 __attribute__((ext_vector_type(4)));
typedef unsigned u32x4 __attribute__((ext_vector_type(4)));
typedef unsigned u32x2 __attribute__((ext_vector_type(2)));

__device__ __forceinline__ unsigned f2bf(float f) { unsigned u = __builtin_bit_cast(unsigned, f); return (u + 0x7fffu + ((u >> 16) & 1u)) >> 16; }
__device__ __forceinline__ float bf2f(unsigned h) { return __builtin_bit_cast(float, (h & 0xffffu) << 16); }
__device__ __forceinline__ unsigned pk2(float lo, float hi) { return f2bf(lo) | (f2bf(hi) << 16); }
__device__ __forceinline__ float wave_sum(float v) {
#pragma unroll
    for (int o = 1; o < 64; o <<= 1) v += __shfl_xor(v, o);
    return v;
}
__device__ __forceinline__ float wave_max(float v) {
#pragma unroll
    for (int o = 1; o < 64; o <<= 1) v = fmaxf(v, __shfl_xor(v, o));
    return v;
}
__device__ __forceinline__ float sigmoidf_(float v) { return 1.0f / (1.0f + __expf(-v)); }

__device__ const unsigned char BUCKET[128] = {0, 1, 2, 3, 4, 5, 6, 7, 8, 9, 10, 11, 12, 13, 14, 15, 16, 16, 16, 17, 17, 18, 18, 18, 19, 19, 19, 20, 20, 20, 20, 21, 21, 21, 21, 22, 22, 22, 22, 22, 23, 23, 23, 23, 23, 23, 24, 24, 24, 24, 24, 24, 25, 25, 25, 25, 25, 25, 25, 26, 26, 26, 26, 26, 26, 26, 26, 27, 27, 27, 27, 27, 27, 27, 27, 27, 27, 28, 28, 28, 28, 28, 28, 28, 28, 28, 28, 29, 29, 29, 29, 29, 29, 29, 29, 29, 29, 29, 29, 30, 30, 30, 30, 30, 30, 30, 30, 30, 30, 30, 30, 30, 30, 31, 31, 31, 31, 31, 31, 31, 31, 31, 31, 31, 31, 31, 31, 31};

constexpr size_t MiB = 1u << 20;
constexpr size_t WS_XN = 32 * MiB;
constexpr size_t WS_QKV = 96 * MiB;
constexpr size_t WS_G = 144 * MiB;
constexpr size_t WS_AO = 176 * MiB;
constexpr size_t WS_ACT = 240 * MiB;
constexpr size_t WS_S = 416 * MiB;
constexpr size_t WS_MIX = 240 * MiB;
constexpr size_t WS_FF = 32 * MiB;
constexpr size_t WS_END = 448 * MiB;

__global__ void __launch_bounds__(256) k_rmsnorm_bf16(const float* __restrict__ x, const float* __restrict__ g, bf16* __restrict__ out) {
    const int lane = threadIdx.x & 63, row = blockIdx.x * 4 + (threadIdx.x >> 6);
    const f32x4* xr = (const f32x4*)(x + (size_t)row * DM) + lane;
    f32x4 v[4]; float s = 0.f;
#pragma unroll
    for (int j = 0; j < 4; ++j) { v[j] = xr[64 * j]; s += (v[j].x * v[j].x + v[j].y * v[j].y) + (v[j].z * v[j].z + v[j].w * v[j].w); }
    const float r = 1.0f / sqrtf(wave_sum(s) * (1.0f / DM) + EPS);
    u32x2* o = (u32x2*)(out + (size_t)row * DM) + lane;
#pragma unroll
    for (int j = 0; j < 4; ++j) { const f32x4 gg = ((const f32x4*)g)[lane + 64 * j]; u32x2 w; w.x = pk2(v[j].x * r * gg.x, v[j].y * r * gg.y); w.y = pk2(v[j].z * r * gg.z, v[j].w * r * gg.w); o[64 * j] = w; }
}

struct EpiStoreBf16 { bf16* O; int ldc; int pad; __device__ void operator()(int r, int c, float v1, float) const { O[(size_t)r * ldc + c] = (bf16)f2bf(v1); } };
struct EpiStoreF32 { float* O; int ldc; int pad; __device__ void operator()(int r, int c, float v1, float) const { O[(size_t)r * ldc + c] = v1; } };
struct EpiGlu { bf16* O; int ldc; int pad; __device__ void operator()(int r, int c, float v1, float v2) const { O[(size_t)r * ldc + c] = (bf16)f2bf(v1 * sigmoidf_(v2)); } };
struct EpiSwiGlu { bf16* O; int ldc; int pad; __device__ void operator()(int r, int c, float v1, float v2) const { O[(size_t)r * ldc + c] = (bf16)f2bf(v1 * sigmoidf_(v1) * v2); } };

template <bool DUAL, class Epi>
__global__ void __launch_bounds__(256) k_gemm_naive(const bf16* __restrict__ A, const float* __restrict__ W1, const float* __restrict__ W2, int lda, int ldw, int K, int pad_, Epi E) {
    __shared__ float As[16][68];
    __shared__ float B1s[16][68];
    __shared__ float B2s[16][68];
    const int t = threadIdx.x, tx = t & 15, ty = t >> 4;
    const int row0 = blockIdx.y * 64, col0 = blockIdx.x * 64;
    float acc1[4][4], acc2[4][4];
#pragma unroll
    for (int i = 0; i < 4; ++i)
#pragma unroll
        for (int j = 0; j < 4; ++j) { acc1[i][j] = 0.f; acc2[i][j] = 0.f; }
    const int ar = t >> 2, ak = (t & 3) * 4;
    const int bk = t >> 4, bc = (t & 15) * 4;
    for (int k0 = 0; k0 < K; k0 += 16) {
        const u32x2 av = *(const u32x2*)(A + (size_t)(row0 + ar) * lda + k0 + ak);
        const f32x4 b1 = *(const f32x4*)(W1 + (size_t)(k0 + bk) * ldw + col0 + bc);
        f32x4 b2 = (f32x4){0.f, 0.f, 0.f, 0.f};
        if (DUAL) b2 = *(const f32x4*)(W2 + (size_t)(k0 + bk) * ldw + col0 + bc);
        __syncthreads();
        As[ak + 0][ar] = bf2f(av.x); As[ak + 1][ar] = bf2f(av.x >> 16); As[ak + 2][ar] = bf2f(av.y); As[ak + 3][ar] = bf2f(av.y >> 16);
        *(f32x4*)&B1s[bk][bc] = b1;
        if (DUAL) *(f32x4*)&B2s[bk][bc] = b2;
        __syncthreads();
#pragma unroll
        for (int k = 0; k < 16; ++k) {
            const f32x4 a = *(const f32x4*)&As[k][ty * 4];
            const f32x4 b = *(const f32x4*)&B1s[k][tx * 4];
#pragma unroll
            for (int i = 0; i < 4; ++i)
#pragma unroll
                for (int j = 0; j < 4; ++j) acc1[i][j] += a[i] * b[j];
            if (DUAL) {
                const f32x4 c = *(const f32x4*)&B2s[k][tx * 4];
#pragma unroll
                for (int i = 0; i < 4; ++i)
#pragma unroll
                    for (int j = 0; j < 4; ++j) acc2[i][j] += a[i] * c[j];
            }
        }
    }
#pragma unroll
    for (int i = 0; i < 4; ++i)
#pragma unroll
        for (int j = 0; j < 4; ++j) E(row0 + ty * 4 + i, col0 + tx * 4 + j, acc1[i][j], acc2[i][j]);
}

__global__ void __launch_bounds__(256) k_attn_naive(const bf16* __restrict__ QKV, const float* __restrict__ sinks, const float* __restrict__ rel_bias, bf16* __restrict__ AO) {
    const int lane = threadIdx.x & 63, w = blockIdx.x * 4 + (threadIdx.x >> 6);
    const int token = w >> 3, head = w & 7, kvh = head >> 2, t = token % SEQ;
    const float ql = bf2f(QKV[(size_t)token * QKVW + head * HD + lane]);
    const int d0 = lane, d1 = lane + 64;
    const bool v0 = (t - d0) >= 0, v1 = (t - d1) >= 0;
    const bf16* k0p = QKV + (size_t)(v0 ? token - d0 : token) * QKVW + DQ + kvh * HD;
    const bf16* k1p = QKV + (size_t)(v1 ? token - d1 : token) * QKVW + DQ + kvh * HD;
    float s0 = 0.f, s1 = 0.f;
    for (int d = 0; d < HD; ++d) { const float qd = __shfl(ql, d); s0 += qd * bf2f(k0p[d]); s1 += qd * bf2f(k1p[d]); }
    s0 = s0 * 0.125f + rel_bias[BUCKET[d0] * NH + head];
    s1 = s1 * 0.125f + rel_bias[BUCKET[d1] * NH + head];
    if (!v0) s0 = -INFINITY;
    if (!v1) s1 = -INFINITY;
    const float sink = sinks[head];
    const float m = fmaxf(wave_max(fmaxf(s0, s1)), sink);
    const float p0 = v0 ? __expf(s0 - m) : 0.f, p1 = v1 ? __expf(s1 - m) : 0.f;
    const float denom = wave_sum(p0 + p1) + __expf(sink - m);
    float o = 0.f;
    const bf16* vb = QKV + DQ + DKV + kvh * HD + lane;
    for (int d = 0; d < 64; ++d) {
        const float pa = __shfl(p0, d), pb = __shfl(p1, d);
        if (t - d >= 0) o += pa * bf2f(vb[(size_t)(token - d) * QKVW]);
        if (t - d - 64 >= 0) o += pb * bf2f(vb[(size_t)(token - d - 64) * QKVW]);
    }
    AO[(size_t)token * DM + head * HD + lane] = (bf16)f2bf(o / denom);
}

__global__ void __launch_bounds__(256) k_conv_naive(const bf16* __restrict__ G, const float* __restrict__ dw, const float* __restrict__ dwb, const float* __restrict__ lng, const float* __restrict__ lnb, bf16* __restrict__ S) {
    const int lane = threadIdx.x & 63, token = blockIdx.x * 4 + (threadIdx.x >> 6), t = token % SEQ, c = lane * 8;
    float h[8];
#pragma unroll
    for (int i = 0; i < 8; ++i) h[i] = dwb[c + i];
    for (int j = 0; j < CWID; ++j) {
        const int tt = t - (CWID - 1) + j;
        if (tt < 0) continue;
        const u32x4 gv = *(const u32x4*)(G + (size_t)(token - (CWID - 1) + j) * DCONV + c);
        const f32x4 w0 = *(const f32x4*)(dw + j * DCONV + c), w1 = *(const f32x4*)(dw + j * DCONV + c + 4);
        h[0] += bf2f(gv.x) * w0.x; h[1] += bf2f(gv.x >> 16) * w0.y; h[2] += bf2f(gv.y) * w0.z; h[3] += bf2f(gv.y >> 16) * w0.w;
        h[4] += bf2f(gv.z) * w1.x; h[5] += bf2f(gv.z >> 16) * w1.y; h[6] += bf2f(gv.w) * w1.z; h[7] += bf2f(gv.w >> 16) * w1.w;
    }
    float s = 0.f;
#pragma unroll
    for (int i = 0; i < 8; ++i) s += h[i];
    const float mean = wave_sum(s) * (1.0f / DCONV);
    float q = 0.f;
#pragma unroll
    for (int i = 0; i < 8; ++i) { h[i] -= mean; q += h[i] * h[i]; }
    const float rstd = 1.0f / sqrtf(wave_sum(q) * (1.0f / DCONV) + EPS);
    unsigned o[4];
#pragma unroll
    for (int i = 0; i < 4; ++i) {
        float y0 = h[2 * i] * rstd * lng[c + 2 * i] + lnb[c + 2 * i], y1 = h[2 * i + 1] * rstd * lng[c + 2 * i + 1] + lnb[c + 2 * i + 1];
        o[i] = pk2(y0 * sigmoidf_(y0), y1 * sigmoidf_(y1));
    }
    *(u32x4*)(S + (size_t)token * DCONV + c) = (u32x4){o[0], o[1], o[2], o[3]};
}

__global__ void __launch_bounds__(256) k_res_norm_norm(const float* __restrict__ mix, const float* __restrict__ x, const float* __restrict__ g2, const float* __restrict__ g3, float* __restrict__ out, bf16* __restrict__ xn) {
    const int lane = threadIdx.x & 63, row = blockIdx.x * 4 + (threadIdx.x >> 6);
    const f32x4* mr = (const f32x4*)(mix + (size_t)row * DM) + lane;
    const f32x4* xr = (const f32x4*)(x + (size_t)row * DM) + lane;
    f32x4 v[4]; float s = 0.f;
#pragma unroll
    for (int j = 0; j < 4; ++j) { v[j] = mr[64 * j]; s += (v[j].x * v[j].x + v[j].y * v[j].y) + (v[j].z * v[j].z + v[j].w * v[j].w); }
    const float r2 = 1.0f / sqrtf(wave_sum(s) * (1.0f / DM) + EPS);
    float s2 = 0.f;
#pragma unroll
    for (int j = 0; j < 4; ++j) { const f32x4 gg = ((const f32x4*)g2)[lane + 64 * j]; v[j] = xr[64 * j] + v[j] * r2 * gg; s2 += (v[j].x * v[j].x + v[j].y * v[j].y) + (v[j].z * v[j].z + v[j].w * v[j].w); }
    const float r3 = 1.0f / sqrtf(wave_sum(s2) * (1.0f / DM) + EPS);
    f32x4* orow = (f32x4*)(out + (size_t)row * DM) + lane;
    u32x2* o = (u32x2*)(xn + (size_t)row * DM) + lane;
#pragma unroll
    for (int j = 0; j < 4; ++j) { orow[64 * j] = v[j]; const f32x4 gg = ((const f32x4*)g3)[lane + 64 * j]; u32x2 w; w.x = pk2(v[j].x * r3 * gg.x, v[j].y * r3 * gg.y); w.y = pk2(v[j].z * r3 * gg.z, v[j].w * r3 * gg.w); o[64 * j] = w; }
}
__global__ void __launch_bounds__(256) k_res_norm(const float* __restrict__ ff, const float* __restrict__ g4, float* __restrict__ out) {
    const int lane = threadIdx.x & 63, row = blockIdx.x * 4 + (threadIdx.x >> 6);
    const f32x4* fr = (const f32x4*)(ff + (size_t)row * DM) + lane;
    f32x4 v[4]; float s = 0.f;
#pragma unroll
    for (int j = 0; j < 4; ++j) { v[j] = fr[64 * j]; s += (v[j].x * v[j].x + v[j].y * v[j].y) + (v[j].z * v[j].z + v[j].w * v[j].w); }
    const float r = 1.0f / sqrtf(wave_sum(s) * (1.0f / DM) + EPS);
    f32x4* orow = (f32x4*)(out + (size_t)row * DM) + lane;
#pragma unroll
    for (int j = 0; j < 4; ++j) { const f32x4 gg = ((const f32x4*)g4)[lane + 64 * j]; orow[64 * j] = orow[64 * j] + v[j] * r * gg; }
}

extern "C" void kernel_launch(void* const* d_in, const int* in_sizes, int n_in, void* d_out, int out_size, void* d_ws, size_t ws_size, hipStream_t stream) {
    if (n_in != 17 || in_sizes[0] != M * DM || out_size != M * DM || ws_size < WS_END) { fprintf(stderr, "kernel_launch: unexpected shapes (n_in %d, in0 %d, out %d, ws %zu)\n", n_in, n_in > 0 ? in_sizes[0] : -1, out_size, ws_size); return; }
    const float* x = (const float*)d_in[0];
    const float *g_mix_pre = (const float*)d_in[1], *g_mix_post = (const float*)d_in[2], *g_ffn_pre = (const float*)d_in[3], *g_ffn_post = (const float*)d_in[4];
    const float* w_in = (const float*)d_in[5];
    const float *conv_dw = (const float*)d_in[6], *conv_dw_b = (const float*)d_in[7], *conv_ln_g = (const float*)d_in[8], *conv_ln_b = (const float*)d_in[9];
    const float* w_conv_pw = (const float*)d_in[10];
    const float *attn_sinks = (const float*)d_in[11], *rel_bias = (const float*)d_in[12];
    const float *w_out = (const float*)d_in[13], *w_gate = (const float*)d_in[14], *w_up = (const float*)d_in[15], *w_down = (const float*)d_in[16];
    float* out = (float*)d_out; unsigned char* ws = (unsigned char*)d_ws;
    bf16 *XN = (bf16*)(ws + WS_XN), *QKV = (bf16*)(ws + WS_QKV), *G = (bf16*)(ws + WS_G), *AO = (bf16*)(ws + WS_AO), *ACT = (bf16*)(ws + WS_ACT), *S = (bf16*)(ws + WS_S);
    float *MIX = (float*)(ws + WS_MIX), *FF = (float*)(ws + WS_FF);

    k_rmsnorm_bf16<<<M / 4, 256, 0, stream>>>(x, g_mix_pre, XN);
    k_gemm_naive<false, EpiStoreBf16><<<dim3(QKVW / 64, M / 64), 256, 0, stream>>>(XN, w_in, nullptr, DM, DIN, DM, 0, EpiStoreBf16{QKV, QKVW, 0});
    k_gemm_naive<true, EpiGlu><<<dim3(DCONV / 64, M / 64), 256, 0, stream>>>(XN, w_in + QKVW, w_in + QKVW + DCONV, DM, DIN, DM, 0, EpiGlu{G, DCONV, 0});
    k_attn_naive<<<M * NH / 4, 256, 0, stream>>>(QKV, attn_sinks, rel_bias, AO);
    k_conv_naive<<<M / 4, 256, 0, stream>>>(G, conv_dw, conv_dw_b, conv_ln_g, conv_ln_b, S);
    k_gemm_naive<false, EpiStoreBf16><<<dim3(DCONV / 64, M / 64), 256, 0, stream>>>(S, w_conv_pw, nullptr, DCONV, DCONV, DCONV, 0, EpiStoreBf16{AO + DQ, DM, 0});
    k_gemm_naive<false, EpiStoreF32><<<dim3(DM / 64, M / 64), 256, 0, stream>>>(AO, w_out, nullptr, DM, DM, DM, 0, EpiStoreF32{MIX, DM, 0});
    k_res_norm_norm<<<M / 4, 256, 0, stream>>>(MIX, x, g_mix_post, g_ffn_pre, out, XN);
    k_gemm_naive<true, EpiSwiGlu><<<dim3(DFF / 64, M / 64), 256, 0, stream>>>(XN, w_gate, w_up, DM, DFF, DM, 0, EpiSwiGlu{ACT, DFF, 0});
    k_gemm_naive<false, EpiStoreF32><<<dim3(DM / 64, M / 64), 256, 0, stream>>>(ACT, w_down, nullptr, DFF, DM, DFF, 0, EpiStoreF32{FF, DM, 0});
    k_res_norm<<<M / 4, 256, 0, stream>>>(FF, g_ffn_post, out);
}
```
